# Optimizing an MI355X kernel written in HIP

```python
import jax, jax.numpy as jnp
from jax import lax
import numpy as np

D_MODEL = 1024
BATCH = 8
SEQ = 2048
DEPTH = 4
DEC_BATCH = 128
DEC_SEQ = 1
PAST_LEN = 16384
PAGE_SIZE = 128

CHUNK = 128
A_GROUPS = 4
D_A = D_MODEL
A_GROUP_DIM = D_A // A_GROUPS
R_HEADS = 4
R_DK = D_MODEL // R_HEADS
R_DV = D_MODEL // R_HEADS
D_R = R_HEADS * R_DV
D_FF = 4 * D_MODEL
D_IN = 2 * D_A + 2 * R_HEADS * R_DK + 2 * D_R + 2 * D_MODEL
ROPE_BASE = 10000.0
EPS = 1e-6

kernel_name = "gated_gmlp_retention_hybrid_step"


def rms_norm(x, g):
    xf = x.astype(jnp.float32)
    y = xf * lax.rsqrt(jnp.mean(xf * xf, axis=-1, keepdims=True) + EPS)
    return (y * g.astype(jnp.float32)).astype(x.dtype)


def layer_norm(x, g, b):
    xf = x.astype(jnp.float32)
    mu = jnp.mean(xf, axis=-1, keepdims=True)
    var = jnp.mean(jnp.square(xf - mu), axis=-1, keepdims=True)
    return ((xf - mu) * lax.rsqrt(var + EPS) * g.astype(jnp.float32) + b.astype(jnp.float32)).astype(x.dtype)


def rotary(x, pos):
    half = x.shape[-1] // 2
    inv = ROPE_BASE ** (-jnp.arange(half, dtype=jnp.float32) / half)
    ang = pos[:, None] * inv[None, :]
    cos = jnp.cos(ang)[None, :, None, :]
    sin = jnp.sin(ang)[None, :, None, :]
    x1, x2 = x[..., :half], x[..., half:]
    return jnp.concatenate([x1 * cos - x2 * sin, x1 * sin + x2 * cos], axis=-1)


def chunk_mlp(u, v, w_s, b_s):
    B, T, _ = v.shape
    L = CHUNK if T % CHUNK == 0 else T
    n = T // L
    mask = jnp.tril(jnp.ones((L, L), dtype=bool))
    w = jnp.where(mask[None], w_s[:, :L, :L], jnp.zeros((), w_s.dtype)).astype(v.dtype)
    vc = v.reshape(B, n, L, A_GROUPS, A_GROUP_DIM)
    z = jnp.einsum('gts,bnsgd->bntgd', w, vc) + b_s[:, :L].T.astype(v.dtype)[None, None, :, :, None]
    return u * z.reshape(B, T, D_A)


def retention(q, k, v, state0):
    B, T = q.shape[:2]
    L = CHUNK if T % CHUNK == 0 else T
    n = T // L
    log_g = jnp.log1p(-jnp.exp2(-5.0 - jnp.arange(R_HEADS, dtype=jnp.float32)))
    idx = jnp.arange(L, dtype=jnp.float32)
    diff = idx[:, None] - idx[None, :]
    decay = jnp.where(diff[None] >= 0.0,
                      jnp.exp(jnp.maximum(diff, 0.0)[None] * log_g[:, None, None]), 0.0)
    xi = jnp.exp((idx[:, None] + 1.0) * log_g[None, :])
    zeta = jnp.exp((L - 1.0 - idx)[:, None] * log_g[None, :])
    g_L = jnp.exp(L * log_g)

    def split(t):
        return t.reshape(B, n, L, *t.shape[2:]).swapaxes(0, 1)

    def step(S, blk):
        qc, kc, vc = blk
        sc = jnp.einsum('blhk,bmhk->bhlm', qc, kc) * decay[None]
        o = (jnp.einsum('bhlm,bmhv->blhv', sc, vc)
             + jnp.einsum('blhk,bhkv->blhv', qc, S) * xi[None, :, :, None])
        S = S * g_L[None, :, None, None] + jnp.einsum('blhk,blhv->bhkv', kc * zeta[None, :, :, None], vc)
        return S, o

    S, o = lax.scan(step, state0, (split(q), split(k), split(v)))
    return o.swapaxes(0, 1).reshape(B, T, R_HEADS, R_DV), S


def trunk(x, c, pos0, ret_state0, w_ada, b_ada, norm1_g, w_in, ln_v_g, ln_v_b, w_s, b_s,
          gn_g, w_out, norm2_g, w_ff1, w_ff2, final_g):
    B, T, _ = x.shape
    pos = pos0 + jnp.arange(T, dtype=jnp.float32)
    sizes = [D_A, D_A, R_HEADS * R_DK, R_HEADS * R_DK, D_R, D_R, D_MODEL]
    offs = []
    s = 0
    for n_cols in sizes:
        s += n_cols
        offs.append(s)
    ret_states, v_rows = [], []
    for l in range(DEPTH):
        mod = (c @ w_ada[l] + b_ada[l])[:, None, :]
        sh1, sc1, gt1, sh2, sc2, gt2 = jnp.split(mod, 6, axis=-1)
        h = rms_norm(x, norm1_g[l]) * (1.0 + sc1) + sh1
        proj = h @ w_in[l]
        u, va, q, k, vr, g, ga, gb = jnp.split(proj, offs, axis=-1)
        va_n = layer_norm(va, ln_v_g[l], ln_v_b[l])
        a = chunk_mlp(u, va_n, w_s[l], b_s[l])
        v_rows.append(va_n)
        qh = rotary(q.reshape(B, T, R_HEADS, R_DK).astype(jnp.float32), pos)
        kh = rotary(k.reshape(B, T, R_HEADS, R_DK).astype(jnp.float32), pos) * (R_DK ** -0.5)
        vh = vr.reshape(B, T, R_HEADS, R_DV).astype(jnp.float32)
        if ret_state0 is None:
            S0 = jnp.zeros((B, R_HEADS, R_DK, R_DV), jnp.float32)
        else:
            S0 = ret_state0[l].astype(jnp.float32)
        o, S = retention(qh, kh, vh, S0)
        ret_states.append(S.astype(x.dtype))
        mu = jnp.mean(o, axis=-1, keepdims=True)
        var = jnp.mean(jnp.square(o - mu), axis=-1, keepdims=True)
        o_n = ((o - mu) * lax.rsqrt(var + EPS)).reshape(B, T, D_R) * gn_g[l].astype(jnp.float32)
        r = (jax.nn.silu(g.astype(jnp.float32)) * o_n).astype(x.dtype)
        m = jax.nn.sigmoid(ga) * a + jax.nn.sigmoid(gb) * r
        x = x + gt1 * (m @ w_out[l])
        h2 = rms_norm(x, norm2_g[l]) * (1.0 + sc2) + sh2
        x = x + gt2 * (jnp.square(jax.nn.relu(h2 @ w_ff1[l])) @ w_ff2[l])
    return rms_norm(x, final_g), jnp.stack(ret_states), jnp.stack(v_rows)


def setup_inputs(seed: int = 0) -> dict:
    key = jax.random.key(seed)
    ks = jax.random.split(key, 24)
    f32 = jnp.float32
    nrm = lambda k, shp, s: jax.random.normal(k, shp, f32) * s
    return {
        "x_prompt": nrm(ks[0], (BATCH, SEQ, D_MODEL), 1.0),
        "x_sample": nrm(ks[1], (DEC_BATCH, DEC_SEQ, D_MODEL), 1.0),
        "state_ret": nrm(ks[2], (DEPTH, DEC_BATCH, R_HEADS, R_DK, R_DV), 0.5),
        "c_prompt": nrm(ks[3], (BATCH, D_MODEL), 1.0),
        "c_sample": nrm(ks[4], (DEC_BATCH, D_MODEL), 1.0),
        "w_ada": nrm(ks[5], (DEPTH, D_MODEL, 6 * D_MODEL), 0.5 * D_MODEL ** -0.5),
        "b_ada": nrm(ks[6], (DEPTH, 6 * D_MODEL), 0.02),
        "norm1_g": 1.0 + nrm(ks[7], (DEPTH, D_MODEL), 0.02),
        "w_in": nrm(ks[8], (DEPTH, D_MODEL, D_IN), D_MODEL ** -0.5),
        "ln_v_g": 1.0 + nrm(ks[9], (DEPTH, D_A), 0.02),
        "ln_v_b": nrm(ks[10], (DEPTH, D_A), 0.02),
        "w_s": nrm(ks[11], (DEPTH, A_GROUPS, CHUNK, CHUNK), CHUNK ** -0.5),
        "b_s": 1.0 + nrm(ks[12], (DEPTH, A_GROUPS, CHUNK), 0.02),
        "gn_g": 1.0 + nrm(ks[13], (DEPTH, D_R), 0.02),
        "w_out": nrm(ks[14], (DEPTH, D_MODEL, D_MODEL), D_MODEL ** -0.5),
        "norm2_g": 1.0 + nrm(ks[15], (DEPTH, D_MODEL), 0.02),
        "w_ff1": nrm(ks[16], (DEPTH, D_MODEL, D_FF), D_MODEL ** -0.5),
        "w_ff2": nrm(ks[17], (DEPTH, D_FF, D_MODEL), D_FF ** -0.5),
        "final_g": 1.0 + nrm(ks[18], (D_MODEL,), 0.02),
    }


def reference(x_prompt, x_sample, state_ret, c_prompt, c_sample, w_ada, b_ada, norm1_g, w_in,
              ln_v_g, ln_v_b, w_s, b_s, gn_g, w_out, norm2_g, w_ff1, w_ff2, final_g):
    y_prompt, new_ret_prompt, _ = trunk(
        x_prompt, c_prompt, 0.0, None, w_ada, b_ada, norm1_g, w_in, ln_v_g, ln_v_b,
        w_s, b_s, gn_g, w_out, norm2_g, w_ff1, w_ff2, final_g)
    y_sample, new_ret_sample, new_chunk_v_sample = trunk(
        x_sample, c_sample, float(PAST_LEN), state_ret, w_ada, b_ada, norm1_g, w_in, ln_v_g, ln_v_b,
        w_s, b_s, gn_g, w_out, norm2_g, w_ff1, w_ff2, final_g)
    return (y_prompt, y_sample, new_ret_prompt, new_ret_sample, new_chunk_v_sample)
```

```cpp
#include <hip/hip_runtime.h>
#include <hip/hip_cooperative_groups.h>
#include <cstdio>
#include <cstdint>
namespace cg = cooperative_groups;
namespace pg8 {
#define PG8_LAS __attribute__((address_space(3)))
typedef unsigned short bf16_t;
typedef short bf16x8 __attribute__((ext_vector_type(8)));
typedef float f32x4 __attribute__((ext_vector_type(4)));
typedef unsigned u32x4 __attribute__((ext_vector_type(4)));
constexpr int BM = 256, BK = 64, HALF = 128, HTB = HALF * BK * 2  , STAGE_BYTES = 8 * HTB, NXCD = 8, WGM = 8;

__host__ __device__ __forceinline__ int lds_byte(int r, int c) { const int st = (r >> 4) * 2 + (c >> 5), rr = r & 15, cc = c & 31, ob = rr * 64 + cc * 2; return st * 1024 + (ob ^ (((ob >> 9) & 1) << 5)); }
__host__ __device__ __forceinline__ void stage_rc(int b, int& R, int& C) { const int st = b / 1024, sb = b % 1024, swz = sb ^ (((sb >> 9) & 1) << 5); R = (st >> 1) * 16 + swz / 64; C = (st & 1) * 32 + (swz % 64) / 2; }
__host__ __device__ __forceinline__ int perm32(int rho) { const int n = rho >> 4, i = rho & 15; return 8 * (i >> 2) + 4 * n + (i & 3); }

struct Unit { int pm, pn; };
struct Gemm { const bf16_t* A; const bf16_t* Bt; int M, N, K; };

struct StaticOrder {
    int nM, nN, nwg, G, c;
    __host__ __device__ void init(int M, int N, int G_, int c_) { nM = M / BM; nN = N / BM; nwg = nM * nN; G = G_; c = c_; }
    __host__ __device__ bool next(int i, Unit& u) const {
        const long L = (long)i * G + c; if (L >= nwg) return false;
        int wgid = (int)L; { const int q = nwg / NXCD, r = nwg % NXCD, xcd = wgid % NXCD, off = wgid / NXCD; wgid = (xcd < r ? xcd * (q + 1) : r * (q + 1) + (xcd - r) * q) + off; }
        const int nig = WGM * nN, gid = wgid / nig, fm = gid * WGM, gsz = (nM - fm) < WGM ? (nM - fm) : WGM;
        u.pm = fm + ((wgid % nig) % gsz); u.pn = (wgid % nig) / gsz; return true;
    }
    __device__ __forceinline__ void a_ready(const Unit&) const {}
    __device__ __forceinline__ void done(const Unit&) const {}
};

__device__ __forceinline__ unsigned cvt_pk_bf16(float lo, float hi) { unsigned r; asm volatile("v_cvt_pk_bf16_f32 %0, %1, %2" : "=v"(r) : "v"(lo), "v"(hi)); return r; }
typedef float f32x2 __attribute__((ext_vector_type(2)));

constexpr int EP_MPROMPT = 16384, EP_MREAL = 16512, EP_MODLD = 24576;
struct EpiBf16Act {
    static constexpr bool PERM = true, AFTER_DRAIN = false;
    bf16_t* O; int ldc; int act;
    __device__ __forceinline__ void operator()(const f32x4 (&acc)[2][2][4][2], const Unit& u, int wr, int wc, int fr, int fq) const {
        const int row0 = u.pm * BM + wr * 64 + fr; const int col0 = u.pn * BM + wc * 32 + 8 * fq;
#pragma unroll
        for (int ai = 0; ai < 2; ++ai)
#pragma unroll
            for (int m = 0; m < 4; ++m) { bf16_t* rowp = O + (size_t)(row0 + ai * HALF + m * 16) * ldc + col0;
#pragma unroll
                for (int bj = 0; bj < 2; ++bj) { f32x4 v0 = acc[ai][bj][m][0], v1 = acc[ai][bj][m][1];
                    if (act) {
#pragma unroll
                        for (int e = 0; e < 4; ++e) { const float a = fmaxf(v0[e], 0.f), b = fmaxf(v1[e], 0.f); v0[e] = a * a; v1[e] = b * b; } }
                    u32x4 w; w.x = cvt_pk_bf16(v0[0], v0[1]); w.y = cvt_pk_bf16(v0[2], v0[3]); w.z = cvt_pk_bf16(v1[0], v1[1]); w.w = cvt_pk_bf16(v1[2], v1[3]);
                    *(u32x4*)(rowp + bj * HALF) = w; } }
    }
};
struct EpiF32Bias {
    static constexpr bool PERM = false, AFTER_DRAIN = false;
    float* O; int ldc; const float* bias;
    __device__ __forceinline__ void operator()(const f32x4 (&acc)[2][2][4][2], const Unit& u, int wr, int wc, int fr, int fq) const {
        const int row0 = u.pm * BM + wr * 64 + fr; const int col0 = u.pn * BM + wc * 32 + 4 * fq;
#pragma unroll
        for (int bj = 0; bj < 2; ++bj)
#pragma unroll
            for (int n = 0; n < 2; ++n) { const int col = col0 + bj * HALF + n * 16; const f32x4 bv = *(const f32x4*)(bias + col);
#pragma unroll
                for (int ai = 0; ai < 2; ++ai)
#pragma unroll
                    for (int m = 0; m < 4; ++m) *(f32x4*)(O + (size_t)(row0 + ai * HALF + m * 16) * ldc + col) = acc[ai][bj][m][n] + bv; }
    }
};
struct EpiResGate {
    static constexpr bool PERM = false, AFTER_DRAIN = false;
    float* X; const float* gate;
    __device__ __forceinline__ void operator()(const f32x4 (&acc)[2][2][4][2], const Unit& u, int wr, int wc, int fr, int fq) const {
        const int row0 = u.pm * BM + wr * 64 + fr; const int col0 = u.pn * BM + wc * 32 + 4 * fq;
#pragma unroll
        for (int ai = 0; ai < 2; ++ai)
#pragma unroll
            for (int m = 0; m < 4; ++m) { const int row = row0 + ai * HALF + m * 16;
                if (row < EP_MREAL) { const int bi = row < EP_MPROMPT ? (row >> 11) : (8 + row - EP_MPROMPT);
                    const float* gp = gate + (size_t)bi * EP_MODLD + col0; float* xp = X + (size_t)row * 1024 + col0;
#pragma unroll
                    for (int bj = 0; bj < 2; ++bj)
#pragma unroll
                        for (int n = 0; n < 2; ++n) { const int co = bj * HALF + n * 16; const f32x4 gv = *(const f32x4*)(gp + co); f32x4 xv = *(const f32x4*)(xp + co);
                            xv = xv + gv * acc[ai][bj][m][n]; *(f32x4*)(xp + co) = xv; } } }
    }
};

template <class Epi, class Sched, bool ALIGN_EPI = false, bool SP2 = false>
__device__ __forceinline__ void gemm_phase(PG8_LAS unsigned char* lds, const Gemm g, const Sched& S, const Epi& E) {
    const int tid = threadIdx.x, wid = __builtin_amdgcn_readfirstlane(tid >> 6), lane = tid & 63, wr = wid >> 2, wc = wid & 3, fr = lane & 15, fq = lane >> 4;
    const int K = g.K, nt = K / BK;
    unsigned voffA[2], voffB[2];
#pragma unroll
    for (int i = 0; i < 2; ++i) { int R, C; stage_rc(tid * 16 + i * 8192, R, C); const int Rb = Epi::PERM ? ((R & ~31) + perm32(R & 31)) : R;
        voffA[i] = (unsigned)(R * K + C) * 2u; voffB[i] = (unsigned)(Rb * K + C) * 2u; }
    const size_t kstep = (size_t)(BK * 2);
    const size_t hstep = (size_t)HALF * K * 2;
    const size_t tstep = 2 * hstep;
    const unsigned ldsw = (unsigned)wid * 1024u;
    const int aoff = lds_byte(wr * 64 + fr, fq * 8), boff = lds_byte(wc * 32 + fr, fq * 8);
#define PG8_SA(b, h) (((b) * 2 + (h)) * HTB)
#define PG8_SB(b, h) ((4 + (b) * 2 + (h)) * HTB)
#define PG8_STAGE(bufoff, gbase, voff) do { _Pragma("unroll") for (int _i = 0; _i < 2; ++_i) \
        __builtin_amdgcn_global_load_lds((const unsigned*)((const char*)(gbase) + (voff)[_i]), (PG8_LAS unsigned*)(lds + (bufoff) + ldsw + _i * 8192), 16, 0, 0); } while (0)
#define PG8_LDA(dst, b, h) do { _Pragma("unroll") for (int m = 0; m < 4; ++m) _Pragma("unroll") for (int k = 0; k < 2; ++k) dst[m][k] = *(const PG8_LAS bf16x8*)(lds + PG8_SA(b, h) + aoff + m * 2048 + k * 1024); } while (0)
#define PG8_LDB(dst, b, h) do { _Pragma("unroll") for (int n = 0; n < 2; ++n) _Pragma("unroll") for (int k = 0; k < 2; ++k) dst[n][k] = *(const PG8_LAS bf16x8*)(lds + PG8_SB(b, h) + boff + n * 2048 + k * 1024); } while (0)
#define PG8_MMA(ai, bj, At, Bt) do { __builtin_amdgcn_s_setprio(1); _Pragma("unroll") for (int m = 0; m < 4; ++m) _Pragma("unroll") for (int n = 0; n < 2; ++n) _Pragma("unroll") for (int k = 0; k < 2; ++k) \
        acc[ai][bj][m][n] = __builtin_amdgcn_mfma_f32_16x16x32_bf16(Bt[n][k], At[m][k], acc[ai][bj][m][n], 0, 0, 0); __builtin_amdgcn_s_setprio(0); } while (0)
#define PG8_WAIT_V(n) asm volatile("s_waitcnt vmcnt(" #n ")" ::: "memory")
#define PG8_WAIT_L(n) asm volatile("s_waitcnt lgkmcnt(" #n ")" ::: "memory")
#define PG8_BAR __builtin_amdgcn_s_barrier()
#define PG8_SCHED __builtin_amdgcn_sched_barrier(0)
    Unit cur, nxt; int ui = 0;
    if (!S.next(0, cur)) return;
    f32x4 acc[2][2][4][2];
#pragma unroll
    for (int a = 0; a < 2; ++a)
#pragma unroll
        for (int b = 0; b < 2; ++b)
#pragma unroll
            for (int m = 0; m < 4; ++m)
#pragma unroll
                for (int n = 0; n < 2; ++n) acc[a][b][m][n] = (f32x4){0.f, 0.f, 0.f, 0.f};
    bf16x8 At[4][2], B0[2][2], B1[2][2];
    const char* cA = (const char*)g.A + (size_t)cur.pm * tstep; const char* cB = (const char*)g.Bt + (size_t)cur.pn * tstep;
    S.a_ready(cur);
    if constexpr (SP2) {
        PG8_STAGE(PG8_SB(0, 0), cB, voffB); PG8_STAGE(PG8_SB(0, 1), cB + hstep, voffB); PG8_STAGE(PG8_SA(0, 0), cA, voffA); PG8_STAGE(PG8_SA(0, 1), cA + hstep, voffA);
        if (wr == 1) PG8_BAR;
        PG8_WAIT_V(2); PG8_BAR;
        PG8_STAGE(PG8_SB(1, 0), cB + kstep, voffB); PG8_STAGE(PG8_SA(1, 0), cA + kstep, voffA); PG8_STAGE(PG8_SB(1, 1), cB + hstep + kstep, voffB);
        PG8_WAIT_V(6); PG8_BAR;
    } else {
        PG8_STAGE(PG8_SB(0, 0), cB, voffB); PG8_STAGE(PG8_SA(0, 0), cA, voffA); PG8_STAGE(PG8_SB(0, 1), cB + hstep, voffB); PG8_STAGE(PG8_SA(0, 1), cA + hstep, voffA);
        if (wr == 1) PG8_BAR;
        PG8_WAIT_V(4); PG8_BAR;
        PG8_STAGE(PG8_SB(1, 0), cB + kstep, voffB); PG8_STAGE(PG8_SA(1, 0), cA + kstep, voffA); PG8_STAGE(PG8_SB(1, 1), cB + hstep + kstep, voffB);
        PG8_WAIT_V(6); PG8_BAR;
    }
    for (;;) {
        const bool has_next = S.next(ui + 1, nxt);
        const char* nA = has_next ? (const char*)g.A + (size_t)nxt.pm * tstep : cA; const char* nB = has_next ? (const char*)g.Bt + (size_t)nxt.pn * tstep : cB;
        for (int t = 0; t < nt; t += 2) {
            const bool last = (t == nt - 2);
            const char* a1 = cA + (size_t)(t + 1) * kstep;
            const char* a2 = last ? nA : cA + (size_t)(t + 2) * kstep; const char* b2 = last ? nB : cB + (size_t)(t + 2) * kstep;
            const char* a3 = a2 + kstep; const char* b3 = b2 + kstep;
            if (last && has_next) S.a_ready(nxt);
            if constexpr (SP2) {
            PG8_LDB(B0, 0, 0); PG8_LDB(B1, 0, 1); PG8_SCHED; PG8_LDA(At, 0, 0); PG8_STAGE(PG8_SA(1, 1), a1 + hstep, voffA);
            PG8_WAIT_V(8); PG8_WAIT_L(0); PG8_BAR; PG8_MMA(0, 0, At, B0); PG8_MMA(0, 1, At, B1); PG8_BAR; PG8_SCHED;
            PG8_LDA(At, 0, 1); PG8_STAGE(PG8_SB(0, 0), b2, voffB); PG8_STAGE(PG8_SB(0, 1), b2 + hstep, voffB); PG8_STAGE(PG8_SA(0, 0), a2, voffA);
            PG8_WAIT_V(8); PG8_WAIT_L(0); PG8_BAR; PG8_MMA(1, 0, At, B0); PG8_MMA(1, 1, At, B1); PG8_BAR; PG8_SCHED;
            PG8_LDB(B0, 1, 0); PG8_LDB(B1, 1, 1); PG8_SCHED; PG8_LDA(At, 1, 0); PG8_STAGE(PG8_SA(0, 1), a2 + hstep, voffA);
            PG8_WAIT_V(8); PG8_WAIT_L(0); PG8_BAR; PG8_MMA(0, 0, At, B0); PG8_MMA(0, 1, At, B1); PG8_BAR; PG8_SCHED;
            PG8_LDA(At, 1, 1); PG8_STAGE(PG8_SB(1, 0), b3, voffB); PG8_STAGE(PG8_SB(1, 1), b3 + hstep, voffB); PG8_STAGE(PG8_SA(1, 0), a3, voffA);
            PG8_WAIT_V(8); PG8_WAIT_L(0); PG8_BAR; PG8_MMA(1, 0, At, B0); PG8_MMA(1, 1, At, B1); PG8_BAR; PG8_SCHED;
            } else {
            PG8_LDB(B0, 0, 0); PG8_SCHED; PG8_LDA(At, 0, 0); PG8_STAGE(PG8_SA(1, 1), a1 + hstep, voffA);
            PG8_WAIT_L(8); PG8_BAR; PG8_WAIT_L(0); PG8_MMA(0, 0, At, B0); PG8_BAR; PG8_SCHED;
            PG8_LDB(B1, 0, 1); PG8_STAGE(PG8_SB(0, 0), b2, voffB);
            PG8_BAR; PG8_WAIT_L(0); PG8_MMA(0, 1, At, B1); PG8_BAR;
            PG8_LDA(At, 0, 1); PG8_STAGE(PG8_SA(0, 0), a2, voffA);
            PG8_BAR; PG8_WAIT_L(0); PG8_MMA(1, 0, At, B0); PG8_BAR; PG8_SCHED;
            PG8_STAGE(PG8_SB(0, 1), b2 + hstep, voffB);
            PG8_WAIT_V(6); PG8_BAR; PG8_MMA(1, 1, At, B1); PG8_BAR;
            PG8_LDB(B0, 1, 0); PG8_SCHED; PG8_LDA(At, 1, 0); PG8_STAGE(PG8_SA(0, 1), a2 + hstep, voffA);
            PG8_WAIT_L(8); PG8_BAR; PG8_WAIT_L(0); PG8_MMA(0, 0, At, B0); PG8_BAR; PG8_SCHED;
            PG8_LDB(B1, 1, 1); PG8_STAGE(PG8_SB(1, 0), b3, voffB);
            PG8_BAR; PG8_WAIT_L(0); PG8_MMA(0, 1, At, B1); PG8_BAR;
            PG8_LDA(At, 1, 1); PG8_STAGE(PG8_SA(1, 0), a3, voffA);
            PG8_BAR; PG8_WAIT_L(0); PG8_MMA(1, 0, At, B0); PG8_BAR; PG8_SCHED;
            PG8_STAGE(PG8_SB(1, 1), b3 + hstep, voffB);
            PG8_WAIT_V(6); PG8_BAR; PG8_MMA(1, 1, At, B1); PG8_BAR;
            }
        }
        if constexpr (ALIGN_EPI) { if (wr == 0) PG8_BAR; }
        if constexpr (!Epi::AFTER_DRAIN) { E(acc, cur, wr, wc, fr, fq); S.done(cur); }
        if (!has_next) break;
#pragma unroll
        for (int a = 0; a < 2; ++a)
#pragma unroll
            for (int b = 0; b < 2; ++b)
#pragma unroll
                for (int m = 0; m < 4; ++m)
#pragma unroll
                    for (int n = 0; n < 2; ++n) acc[a][b][m][n] = (f32x4){0.f, 0.f, 0.f, 0.f};
        cur = nxt; cA = nA; cB = nB; ++ui;
        if constexpr (ALIGN_EPI) { if (wr == 1) PG8_BAR; }
    }
    PG8_WAIT_V(0);
    if constexpr (!ALIGN_EPI) { if (wr == 0) PG8_BAR; }
    PG8_BAR;
    if constexpr (Epi::AFTER_DRAIN) { E.fused(acc, cur, wr, wc, fr, fq, lds, wid, lane); S.done(cur); }
#undef PG8_SA
#undef PG8_SB
#undef PG8_STAGE
#undef PG8_LDA
#undef PG8_LDB
#undef PG8_MMA
#undef PG8_WAIT_V
#undef PG8_WAIT_L
#undef PG8_BAR
#undef PG8_SCHED
}
}

#define LAS __attribute__((address_space(3)))
typedef unsigned short bf16;
typedef short bf16x8 __attribute__((ext_vector_type(8)));
typedef short s16x4 __attribute__((ext_vector_type(4)));
typedef short v4i16_t __attribute__((ext_vector_type(4)));
typedef float f32x4 __attribute__((ext_vector_type(4)));
typedef unsigned u32x4 __attribute__((ext_vector_type(4)));
typedef unsigned u32x2 __attribute__((ext_vector_type(2)));
typedef LAS unsigned char* ldsp;

constexpr int NWAVES = 8, NTHR = 512;
constexpr int D = 1024, MPROMPT = 16384, NSMP = 128, MREAL = 16512, MP = 16640;
constexpr int DIN = 8192, DFF = 4096, NL = 4;
constexpr int C_U = 0, C_VA = 1024, C_Q = 2048, C_K = 3072, C_VR = 4096, C_G = 5120, C_GA = 6144, C_GB = 7168;
constexpr int MODLD = 24576;
constexpr float EPS = 1e-6f;
constexpr size_t OUT_YP = 0, OUT_YS = 16777216, OUT_RP = 16908288, OUT_RS = 25296896, OUT_CV = 159514624, OUT_TOTAL = 160038912;
constexpr size_t MiB = (size_t)1 << 20;
constexpr size_t WS_TAB = 1 * MiB;
constexpr size_t WS_CB = 4 * MiB;
constexpr size_t WS_MOD = 8 * MiB;
constexpr size_t WS_WADA = 40 * MiB;
constexpr size_t WS_WIN = 88 * MiB;
constexpr size_t WS_WOUT = 152 * MiB;
constexpr size_t WS_WFF1 = 160 * MiB;
constexpr size_t WS_WFF2 = 192 * MiB;
constexpr size_t WS_X = 224 * MiB;
constexpr size_t WS_HN = 292 * MiB;
constexpr size_t WS_OB = 326 * MiB;
constexpr size_t WS_PROJ = 360 * MiB;
constexpr size_t WS_END = 620 * MiB;
constexpr int TABROWS = 2049;
constexpr int LDS_BYTES = 147456;

struct Args { const float* in[19]; float* out; unsigned char* ws; int ph_lo, ph_hi, coop, pad; };
typedef const __attribute__((address_space(4))) unsigned char* kargp;
__device__ __forceinline__ kargp karg_base() { kargp p = (kargp)__builtin_amdgcn_kernarg_segment_ptr(); asm volatile("" : "+s"(p)); return p; }
#define ARG_IN(i) (*(const float* const __attribute__((address_space(4)))*)(karg_base() + 8 * (i)))
#define ARG_OUT (*(float* const __attribute__((address_space(4)))*)(karg_base() + 152))
#define ARG_WS (*(unsigned char* const __attribute__((address_space(4)))*)(karg_base() + 160))
#define ARG_I32(off) (*(const int __attribute__((address_space(4)))*)(karg_base() + (off)))
static_assert(sizeof(Args) == 184, "Args layout");

__device__ __forceinline__ float wave_sum(float v) {
#pragma unroll
    for (int o = 1; o < 64; o <<= 1) v += __shfl_xor(v, o);
    return v;
}
__device__ __forceinline__ unsigned pk2(float lo, float hi) { return pg8::cvt_pk_bf16(lo, hi); }
__device__ __forceinline__ float bflo(unsigned w) { return __uint_as_float(w << 16); }
__device__ __forceinline__ float bfhi(unsigned w) { return __uint_as_float(w & 0xffff0000u); }
__device__ __forceinline__ float bf1(unsigned short h) { return __uint_as_float(((unsigned)h) << 16); }
__device__ __forceinline__ f32x4 unpack4(u32x2 w) { return (f32x4){bflo(w.x), bfhi(w.x), bflo(w.y), bfhi(w.y)}; }
__device__ __forceinline__ u32x2 pack4(f32x4 v) { u32x2 w; w.x = pk2(v[0], v[1]); w.y = pk2(v[2], v[3]); return w; }
__device__ __forceinline__ int batch_of_row(int row) { return row < MPROMPT ? (row >> 11) : (8 + row - MPROMPT); }
__device__ __forceinline__ float sigmoidf_(float x) { return 1.0f / (1.0f + __expf(-x)); }
__device__ __forceinline__ bf16x8 frag_row(ldsp base, int stride, int row, int k0, int fq) { return *(const LAS bf16x8*)(base + row * stride + (k0 + fq * 8) * 2); }
__device__ __forceinline__ s16x4 vtr(ldsp p) { return __builtin_bit_cast(s16x4, __builtin_amdgcn_ds_read_tr16_b64_v4i16((LAS v4i16_t*)p)); }
__device__ __forceinline__ bf16x8 frag_tr(ldsp base, int stride, int k0, int c0, int lane) {
    const int g = lane >> 4, q = (lane & 15) >> 2, p = lane & 3;
    ldsp a = base + (k0 + 8 * g + q) * stride + (c0 + 4 * p) * 2;
    const s16x4 lo = vtr(a), hi = vtr(a + 4 * stride);
    return (bf16x8){lo[0], lo[1], lo[2], lo[3], hi[0], hi[1], hi[2], hi[3]};
}
#define MFMA16(a, b, c) __builtin_amdgcn_mfma_f32_16x16x32_bf16((a), (b), (c), 0, 0, 0)

__device__ __forceinline__ void p0_transpose_item(const float* W, int K, int N, bf16* WT, LAS float* scr, int item, int lane) {
    const int nblk = N / 32, kb = item / nblk, nb = item % nblk, k0 = 64 * kb, n0 = 32 * nb;
#pragma unroll 8
    for (int i = 0; i < 32; ++i) { const int kk = 2 * i + (lane >> 5); scr[kk * 33 + (lane & 31)] = W[(size_t)(k0 + kk) * N + n0 + (lane & 31)]; }
    asm volatile("s_waitcnt lgkmcnt(0)" ::: "memory");
    const int c = lane & 7;
#pragma unroll
    for (int j = 0; j < 4; ++j) { const int n = (lane >> 3) + 8 * j; const LAS float* s = scr + (8 * c) * 33 + n;
        u32x4 o; o.x = pk2(s[0 * 33], s[1 * 33]); o.y = pk2(s[2 * 33], s[3 * 33]); o.z = pk2(s[4 * 33], s[5 * 33]); o.w = pk2(s[6 * 33], s[7 * 33]);
        *(u32x4*)(WT + (size_t)(n0 + n) * K + k0 + 8 * c) = o; }
    asm volatile("s_waitcnt lgkmcnt(0)" ::: "memory");
}
__device__ __forceinline__ void phase_prologue(ldsp lds, int gw, int NGW, int wave, int lane) {
    asm volatile("" : "+v"(lane));
    unsigned char* ws = ARG_WS;
    LAS float* scr = (LAS float*)(lds + wave * 16384);
    constexpr int I_ADA = 16 * 192, I_IN = 16 * 256, I_OUT = 16 * 32, I_F1 = 16 * 128, I_F2 = 64 * 32, I_L = I_ADA + I_IN + I_OUT + I_F1 + I_F2;
    for (int it = gw; it < NL * I_L; it += NGW) {
        const int l = it / I_L; int r = it % I_L;
        if (r < I_ADA) { p0_transpose_item(ARG_IN(5) + (size_t)l * 1024 * 6144, 1024, 6144, (bf16*)(ws + WS_WADA) + (size_t)l * 6144 * 1024, scr, r, lane); continue; } r -= I_ADA;
        if (r < I_IN) { p0_transpose_item(ARG_IN(8) + (size_t)l * 1024 * 8192, 1024, 8192, (bf16*)(ws + WS_WIN) + (size_t)l * 8192 * 1024, scr, r, lane); continue; } r -= I_IN;
        if (r < I_OUT) { p0_transpose_item(ARG_IN(14) + (size_t)l * 1024 * 1024, 1024, 1024, (bf16*)(ws + WS_WOUT) + (size_t)l * 1024 * 1024, scr, r, lane); continue; } r -= I_OUT;
        if (r < I_F1) { p0_transpose_item(ARG_IN(16) + (size_t)l * 1024 * 4096, 1024, 4096, (bf16*)(ws + WS_WFF1) + (size_t)l * 4096 * 1024, scr, r, lane); continue; } r -= I_F1;
        p0_transpose_item(ARG_IN(17) + (size_t)l * 4096 * 1024, 4096, 1024, (bf16*)(ws + WS_WFF2) + (size_t)l * 1024 * 4096, scr, r, lane);
    }
    for (int row = gw; row < 256; row += NGW) {
        unsigned long long* o8 = (unsigned long long*)((bf16*)(ws + WS_CB) + (size_t)row * 1024) + lane;
        if (row >= 136) { for (int j = 0; j < 4; ++j) o8[64 * j] = 0ull; continue; }
        const float* src = row < 8 ? ARG_IN(3) + (size_t)row * 1024 : ARG_IN(4) + (size_t)(row - 8) * 1024;
        for (int j = 0; j < 4; ++j) { const f32x4 v = ((const f32x4*)src)[lane + 64 * j]; const u32x2 w = pack4(v); o8[64 * j] = (unsigned long long)w.x | ((unsigned long long)w.y << 32); }
    }
    float* X = (float*)(ws + WS_X);
    for (int row = gw; row < MP; row += NGW) {
        f32x4* o = (f32x4*)(X + (size_t)row * 1024) + lane;
        if (row >= MREAL) { for (int j = 0; j < 4; ++j) o[64 * j] = (f32x4){0.f, 0.f, 0.f, 0.f}; continue; }
        const float* src = row < MPROMPT ? ARG_IN(0) + (size_t)row * 1024 : ARG_IN(1) + (size_t)(row - MPROMPT) * 1024;
        for (int j = 0; j < 4; ++j) o[64 * j] = ((const f32x4*)src)[lane + 64 * j];
    }
    float* tc = (float*)(ws + WS_TAB); float* tsn = tc + TABROWS * 128;
    for (int row = gw; row < TABROWS; row += NGW) {
        const float pos = row < 2048 ? (float)row : 16384.0f;
        for (int jj = 0; jj < 2; ++jj) { const int j = lane + 64 * jj;
            const float inv = exp2f(-(float)j * (13.287712379549449f / 128.0f));
            const float ang = pos * inv; float s, c; sincosf(ang, &s, &c);
            tc[row * 128 + j] = c; tsn[row * 128 + j] = s; }
    }
}

__device__ __forceinline__ void phase_norm_mod(const float* X, const float* g, const float* mod, int sh_part, int sc_part, bf16* HN, int gw, int NGW, int lane) {
    asm volatile("" : "+v"(lane));
    for (int row = gw; row < MP; row += NGW) {
        unsigned long long* o8 = (unsigned long long*)(HN + (size_t)row * 1024) + lane;
        if (row >= MREAL) {
#pragma unroll
            for (int j = 0; j < 4; ++j) o8[64 * j] = 0ull;
            continue; }
        const f32x4* xr = (const f32x4*)(X + (size_t)row * 1024) + lane;
        f32x4 v[4]; float ss = 0.f;
#pragma unroll
        for (int j = 0; j < 4; ++j) { v[j] = xr[64 * j]; ss += (v[j][0] * v[j][0] + v[j][1] * v[j][1]) + (v[j][2] * v[j][2] + v[j][3] * v[j][3]); }
        const float rstd = 1.0f / sqrtf(wave_sum(ss) * (1.0f / 1024.0f) + EPS);
        const float* mrow = mod + (size_t)batch_of_row(row) * MODLD;
#pragma unroll
        for (int j = 0; j < 4; ++j) { const int col = 256 * j + 4 * lane;
            const f32x4 gv = *(const f32x4*)(g + col), sc = *(const f32x4*)(mrow + sc_part * 1024 + col), sh = *(const f32x4*)(mrow + sh_part * 1024 + col);
            const f32x4 h = v[j] * rstd * gv * (sc + 1.0f) + sh; const u32x2 w = pack4(h);
            o8[64 * j] = (unsigned long long)w.x | ((unsigned long long)w.y << 32); }
    }
}
__device__ __forceinline__ void phase_final_norm(const float* X, const float* g, float* out, int gw, int NGW, int lane) {
    asm volatile("" : "+v"(lane));
    for (int row = gw; row < MREAL; row += NGW) {
        const f32x4* xr = (const f32x4*)(X + (size_t)row * 1024) + lane;
        f32x4 v[4]; float ss = 0.f;
#pragma unroll
        for (int j = 0; j < 4; ++j) { v[j] = xr[64 * j]; ss += (v[j][0] * v[j][0] + v[j][1] * v[j][1]) + (v[j][2] * v[j][2] + v[j][3] * v[j][3]); }
        const float rstd = 1.0f / sqrtf(wave_sum(ss) * (1.0f / 1024.0f) + EPS);
        f32x4* o = (f32x4*)(out + (row < MPROMPT ? OUT_YP + (size_t)row * 1024 : OUT_YS + (size_t)(row - MPROMPT) * 1024)) + lane;
#pragma unroll
        for (int j = 0; j < 4; ++j) { const int col = 256 * j + 4 * lane; o[64 * j] = v[j] * rstd * *(const f32x4*)(g + col); }
    }
}
__device__ __forceinline__ void phase_post(bf16* PROJ, const float* lng, const float* lnb, const float* tab, float* out_cv  , int gw, int NGW, int lane) {
    asm volatile("" : "+v"(lane));
    for (int row = gw; row < MREAL; row += NGW) {
        bf16* pr = PROJ + (size_t)row * DIN;
        {   u32x2* vp = (u32x2*)(pr + C_VA) + lane; f32x4 v[4]; float s = 0.f;
#pragma unroll
            for (int j = 0; j < 4; ++j) { v[j] = unpack4(vp[64 * j]); s += (v[j][0] + v[j][1]) + (v[j][2] + v[j][3]); }
            const float mean = wave_sum(s) * (1.0f / 1024.0f); float s2 = 0.f;
#pragma unroll
            for (int j = 0; j < 4; ++j) { v[j] = v[j] - mean; s2 += (v[j][0] * v[j][0] + v[j][1] * v[j][1]) + (v[j][2] * v[j][2] + v[j][3] * v[j][3]); }
            const float rstd = 1.0f / sqrtf(wave_sum(s2) * (1.0f / 1024.0f) + EPS);
#pragma unroll
            for (int j = 0; j < 4; ++j) { const int col = 256 * j + 4 * lane;
                const f32x4 o = v[j] * rstd * *(const f32x4*)(lng + col) + *(const f32x4*)(lnb + col);
                vp[64 * j] = pack4(o);
                if (row >= MPROMPT) *(f32x4*)(out_cv + (size_t)(row - MPROMPT) * 1024 + col) = o; }
        }
        {   const int h = lane >> 4, j0 = (lane & 15) * 8; const int prow = row < MPROMPT ? (row & 2047) : 2048;
            const float* cp = tab + prow * 128 + j0; const float* sp = cp + TABROWS * 128;
            const f32x4 c0 = *(const f32x4*)cp, c1 = *(const f32x4*)(cp + 4), s0 = *(const f32x4*)sp, s1 = *(const f32x4*)(sp + 4);
#pragma unroll
            for (int which = 0; which < 2; ++which) {
                bf16* base = pr + (which ? C_K : C_Q) + h * 256 + j0; const float scale = which ? 0.0625f : 1.0f;
                const u32x4 a = *(const u32x4*)base, b = *(const u32x4*)(base + 128);
                const f32x4 a0 = unpack4((u32x2){a.x, a.y}), a1 = unpack4((u32x2){a.z, a.w}), b0 = unpack4((u32x2){b.x, b.y}), b1 = unpack4((u32x2){b.z, b.w});
                const f32x4 y10 = (a0 * c0 - b0 * s0) * scale, y11 = (a1 * c1 - b1 * s1) * scale, y20 = (a0 * s0 + b0 * c0) * scale, y21 = (a1 * s1 + b1 * c1) * scale;
                const u32x2 p0 = pack4(y10), p1 = pack4(y11), q0 = pack4(y20), q1 = pack4(y21);
                *(u32x4*)base = (u32x4){p0.x, p0.y, p1.x, p1.y}; *(u32x4*)(base + 128) = (u32x4){q0.x, q0.y, q1.x, q1.y};
            }
        }
    }
}
__device__ __forceinline__ void phase_merge(const bf16* PROJ, const bf16* OB, const float* gng, const float* ws_l  , const float* bs_l  , bf16* MB, int gw, int NGW, int lane) {
    asm volatile("" : "+v"(lane));
    for (int row = gw; row < MP; row += NGW) {
        u32x2* mp = (u32x2*)(MB + (size_t)row * 1024) + lane;
        if (row >= MREAL) {
#pragma unroll
            for (int j = 0; j < 4; ++j) mp[64 * j] = (u32x2){0u, 0u};
            continue; }
        const bf16* pr = PROJ + (size_t)row * DIN; const u32x2* op = (const u32x2*)(OB + (size_t)row * 1024) + lane;
#pragma unroll
        for (int j = 0; j < 4; ++j) { const int col = 256 * j + 4 * lane;
            f32x4 o = unpack4(op[64 * j]);
            const float mean = wave_sum((o[0] + o[1]) + (o[2] + o[3])) * (1.0f / 256.0f); o = o - mean;
            const float rstd = 1.0f / sqrtf(wave_sum((o[0] * o[0] + o[1] * o[1]) + (o[2] * o[2] + o[3] * o[3])) * (1.0f / 256.0f) + EPS);
            const f32x4 on = o * rstd * *(const f32x4*)(gng + col);
            const f32x4 g = unpack4(*(const u32x2*)(pr + C_G + col)), ga = unpack4(*(const u32x2*)(pr + C_GA + col)), gb = unpack4(*(const u32x2*)(pr + C_GB + col));
            f32x4 av = unpack4(*(const u32x2*)(pr + C_U + col));
            if (row >= MPROMPT) { const f32x4 vn = unpack4(*(const u32x2*)(pr + C_VA + col)); av = av * (vn * ws_l[j * 16384] + bs_l[j * 128]); }
            f32x4 m;
#pragma unroll
            for (int e = 0; e < 4; ++e) { const float r = g[e] * sigmoidf_(g[e]) * on[e]; m[e] = sigmoidf_(ga[e]) * av[e] + sigmoidf_(gb[e]) * r; }
            mp[64 * j] = pack4(m); }
    }
}

constexpr int LQ = 0, LK = 18432, LV = 36864, LP = 55296, LS = 90112;
constexpr int SQK = 144, SP = 272, SS = 528;
__device__ __forceinline__ void chain_unit(bf16* PROJ, bf16* OB, float* out_rp  , ldsp lds, int b, int h, int vs, int tid) {
    const int wave = __builtin_amdgcn_readfirstlane(tid >> 6), lane = tid & 63, fr = lane & 15, fq = lane >> 4;
    const float log2g = log2f(1.0f - exp2f(-5.0f - (float)h));
    const float gL = exp2f(128.0f * log2g);
    const int wm = wave >> 1, wl = wave & 1;
    const int wv = wave >> 2, wl2 = wave & 3;
    const int wk = wave >> 1, wv2 = wave & 1;
    f32x4 sacc[4][2];
#pragma unroll
    for (int i = 0; i < 4; ++i)
#pragma unroll
        for (int j = 0; j < 2; ++j) sacc[i][j] = (f32x4){0.f, 0.f, 0.f, 0.f};
    const bf16* gq = PROJ + (size_t)(b * 2048) * DIN + C_Q + h * 256;
    const bf16* gk = PROJ + (size_t)(b * 2048) * DIN + C_K + h * 256;
    const bf16* gv = PROJ + (size_t)(b * 2048) * DIN + C_VR + h * 256 + vs * 64;
    const int prow0 = tid >> 3, pc8 = tid & 7;
    u32x4 qr[2], kr[2], vr[2];
#define CH_LOAD_QK(n, kq) do { _Pragma("unroll") for (int i_ = 0; i_ < 2; ++i_) { const size_t o_ = (size_t)((n) * 128 + prow0 + 64 * i_) * DIN + (kq) * 64 + pc8 * 8; \
        qr[i_] = *(const u32x4*)(gq + o_); kr[i_] = *(const u32x4*)(gk + o_); } } while (0)
#define CH_LOAD_V(n) do { _Pragma("unroll") for (int i_ = 0; i_ < 2; ++i_) vr[i_] = *(const u32x4*)(gv + (size_t)((n) * 128 + prow0 + 64 * i_) * DIN + pc8 * 8); } while (0)
#define CH_STORE_QK() do { _Pragma("unroll") for (int i_ = 0; i_ < 2; ++i_) { const int o_ = (prow0 + 64 * i_) * SQK + pc8 * 16; *(LAS u32x4*)(lds + LQ + o_) = qr[i_]; *(LAS u32x4*)(lds + LK + o_) = kr[i_]; } } while (0)
    CH_LOAD_QK(0, 0); CH_LOAD_V(0);
    for (int n = 0; n < 16; ++n) {
        __syncthreads();
#pragma unroll
        for (int i = 0; i < 2; ++i) { const int row = prow0 + 64 * i; const float z = exp2f((float)(127 - row) * log2g);
            const f32x4 a0 = unpack4((u32x2){vr[i].x, vr[i].y}) * z, a1 = unpack4((u32x2){vr[i].z, vr[i].w}) * z; const u32x2 p0 = pack4(a0), p1 = pack4(a1);
            *(LAS u32x4*)(lds + LV + row * SQK + pc8 * 16) = (u32x4){p0.x, p0.y, p1.x, p1.y}; }
        CH_STORE_QK();
#pragma unroll
        for (int kq = 0; kq < 4; ++kq)
#pragma unroll
            for (int nt = 0; nt < 2; ++nt) { const int v = wv2 * 32 + nt * 16 + fr, k0 = kq * 64 + wk * 16 + fq * 4;
                *(LAS u32x2*)(lds + LS + v * SS + k0 * 2) = pack4(sacc[kq][nt]); }
        __syncthreads();
        f32x4 pacc[2][4], oacc[2][2];
#pragma unroll
        for (int i = 0; i < 2; ++i) {
#pragma unroll
            for (int j = 0; j < 4; ++j) pacc[i][j] = (f32x4){0.f, 0.f, 0.f, 0.f};
#pragma unroll
            for (int j = 0; j < 2; ++j) oacc[i][j] = (f32x4){0.f, 0.f, 0.f, 0.f}; }
#pragma unroll
        for (int kq = 0; kq < 4; ++kq) {
            if (kq < 3) { CH_LOAD_QK(n, kq + 1); } else if (n < 15) { CH_LOAD_QK(n + 1, 0); CH_LOAD_V(n + 1); }
#pragma unroll
            for (int ks = 0; ks < 2; ++ks) {
                bf16x8 ka[2], qb[4];
#pragma unroll
                for (int mt = 0; mt < 2; ++mt) ka[mt] = frag_row(lds + LK, SQK, wm * 32 + mt * 16 + fr, ks * 32, fq);
#pragma unroll
                for (int nt = 0; nt < 4; ++nt) qb[nt] = frag_row(lds + LQ, SQK, wl * 64 + nt * 16 + fr, ks * 32, fq);
#pragma unroll
                for (int mt = 0; mt < 2; ++mt)
#pragma unroll
                    for (int nt = 0; nt < 4; ++nt) pacc[mt][nt] = MFMA16(ka[mt], qb[nt], pacc[mt][nt]);
                bf16x8 sa[2], qb2[2];
#pragma unroll
                for (int mt = 0; mt < 2; ++mt) sa[mt] = frag_row(lds + LS, SS, wv * 32 + mt * 16 + fr, kq * 64 + ks * 32, fq);
#pragma unroll
                for (int nt = 0; nt < 2; ++nt) qb2[nt] = frag_row(lds + LQ, SQK, wl2 * 32 + nt * 16 + fr, ks * 32, fq);
#pragma unroll
                for (int mt = 0; mt < 2; ++mt)
#pragma unroll
                    for (int nt = 0; nt < 2; ++nt) oacc[mt][nt] = MFMA16(sa[mt], qb2[nt], oacc[mt][nt]);
            }
#pragma unroll
            for (int nt = 0; nt < 2; ++nt) sacc[kq][nt] = sacc[kq][nt] * gL;
#pragma unroll
            for (int ks = 0; ks < 4; ++ks) {
                const bf16x8 kt = frag_tr(lds + LK, SQK, ks * 32, wk * 16, lane);
#pragma unroll
                for (int nt = 0; nt < 2; ++nt) { const bf16x8 vt = frag_tr(lds + LV, SQK, ks * 32, wv2 * 32 + nt * 16, lane); sacc[kq][nt] = MFMA16(kt, vt, sacc[kq][nt]); }
            }
            __syncthreads();
            if (kq < 3) { CH_STORE_QK(); __syncthreads(); }
        }
#pragma unroll
        for (int mt = 0; mt < 2; ++mt)
#pragma unroll
            for (int nt = 0; nt < 4; ++nt) { const int l = wl * 64 + nt * 16 + fr, m0 = wm * 32 + mt * 16 + fq * 4; f32x4 p = pacc[mt][nt];
#pragma unroll
                for (int r = 0; r < 4; ++r) p[r] = (m0 + r <= l) ? p[r] : 0.f;
                *(LAS u32x2*)(lds + LP + l * SP + m0 * 2) = pack4(p); }
#pragma unroll
        for (int mt = 0; mt < 2; ++mt)
#pragma unroll
            for (int nt = 0; nt < 2; ++nt) oacc[mt][nt] = oacc[mt][nt] * gL;
        __syncthreads();
#pragma unroll
        for (int ks = 0; ks < 4; ++ks) {
            if (ks * 32 <= wl2 * 32 + 31) {
                bf16x8 va[2], pb[2];
#pragma unroll
                for (int mt = 0; mt < 2; ++mt) va[mt] = frag_tr(lds + LV, SQK, ks * 32, wv * 32 + mt * 16, lane);
#pragma unroll
                for (int nt = 0; nt < 2; ++nt) pb[nt] = frag_row(lds + LP, SP, wl2 * 32 + nt * 16 + fr, ks * 32, fq);
#pragma unroll
                for (int mt = 0; mt < 2; ++mt)
#pragma unroll
                    for (int nt = 0; nt < 2; ++nt) oacc[mt][nt] = MFMA16(va[mt], pb[nt], oacc[mt][nt]);
            }
        }
#pragma unroll
        for (int nt = 0; nt < 2; ++nt) { const int l = wl2 * 32 + nt * 16 + fr; const float sc = exp2f((float)(l - 127) * log2g);
            bf16* orow = OB + (size_t)(b * 2048 + n * 128 + l) * 1024 + h * 256 + vs * 64 + wv * 32 + fq * 4;
#pragma unroll
            for (int mt = 0; mt < 2; ++mt) *(u32x2*)(orow + mt * 16) = pack4(oacc[mt][nt] * sc); }
    }
    float* so = out_rp + ((size_t)(b * 4 + h) * 256) * 256 + vs * 64;
#pragma unroll
    for (int kq = 0; kq < 4; ++kq)
#pragma unroll
        for (int nt = 0; nt < 2; ++nt)
#pragma unroll
            for (int r = 0; r < 4; ++r) so[(size_t)(kq * 64 + wk * 16 + fq * 4 + r) * 256 + wv2 * 32 + nt * 16 + fr] = sacc[kq][nt][r];
    __syncthreads();
#undef CH_LOAD_QK
#undef CH_LOAD_V
#undef CH_STORE_QK
}

constexpr int LW = 0, LVN = 34816;
__device__ __forceinline__ void gmlp_unit(bf16* PROJ, const float* wsg  , const float* bsg  , ldsp lds, int row0, int g, int tid) {
    const int wave = __builtin_amdgcn_readfirstlane(tid >> 6), lane = tid & 63, fr = lane & 15, fq = lane >> 4;
    __syncthreads();
#pragma unroll
    for (int i = 0; i < 8; ++i) { const int p = tid + 512 * i, t = p >> 5, s4 = (p & 31) * 4; f32x4 w = *(const f32x4*)(wsg + t * 128 + s4);
#pragma unroll
        for (int e = 0; e < 4; ++e) w[e] = (s4 + e <= t) ? w[e] : 0.f;
        *(LAS u32x2*)(lds + LW + t * SP + s4 * 2) = pack4(w); }
#pragma unroll
    for (int i = 0; i < 8; ++i) { const int p = tid + 512 * i, s = p >> 5, c = p & 31;
        *(LAS u32x4*)(lds + LVN + s * SS + c * 16) = *(const u32x4*)(PROJ + (size_t)(row0 + s) * DIN + C_VA + g * 256 + c * 8); }
    __syncthreads();
    f32x4 z[2][8];
#pragma unroll
    for (int i = 0; i < 2; ++i)
#pragma unroll
        for (int j = 0; j < 8; ++j) z[i][j] = (f32x4){0.f, 0.f, 0.f, 0.f};
#pragma unroll
    for (int ks = 0; ks < 4; ++ks) {
        bf16x8 va[2];
#pragma unroll
        for (int mt = 0; mt < 2; ++mt) va[mt] = frag_tr(lds + LVN, SS, ks * 32, wave * 32 + mt * 16, lane);
#pragma unroll
        for (int nt = 0; nt < 8; ++nt) {
            if (ks * 32 <= nt * 16 + 15) { const bf16x8 wb = frag_row(lds + LW, SP, nt * 16 + fr, ks * 32, fq);
#pragma unroll
                for (int mt = 0; mt < 2; ++mt) z[mt][nt] = MFMA16(va[mt], wb, z[mt][nt]); }
        }
    }
#pragma unroll
    for (int nt = 0; nt < 8; ++nt) { const int t = nt * 16 + fr; const float bias = bsg[t];
#pragma unroll
        for (int mt = 0; mt < 2; ++mt) { u32x2* up = (u32x2*)(PROJ + (size_t)(row0 + t) * DIN + C_U + g * 256 + wave * 32 + mt * 16 + fq * 4);
            const f32x4 u = unpack4(*up); *up = pack4(u * (z[mt][nt] + bias)); } }
}

__device__ __forceinline__ void sample_unit(const bf16* PROJ, bf16* OB, const float* st_in  , float* st_out  , ldsp lds, int s, int h, int tid) {
    LAS float* qf = (LAS float*)lds; LAS float* kf = qf + 256; LAS float* vf = kf + 256; LAS float* part = vf + 256;
    const float gamma = 1.0f - exp2f(-5.0f - (float)h);
    const bf16* pr = PROJ + (size_t)(MPROMPT + s) * DIN + h * 256;
    __syncthreads();
    if (tid < 256) { qf[tid] = bf1(pr[C_Q + tid]); kf[tid] = bf1(pr[C_K + tid]); vf[tid] = bf1(pr[C_VR + tid]); }
    __syncthreads();
    const int cg4 = (tid & 63) * 4, kr0 = tid >> 6;
    const size_t sbase = ((size_t)(s * 4 + h) * 256) * 256;
    const f32x4 vv = *(const LAS f32x4*)(vf + cg4);
    f32x4 qs = (f32x4){0.f, 0.f, 0.f, 0.f};
#pragma unroll 8
    for (int i = 0; i < 32; ++i) { const int k = kr0 + 8 * i; const size_t o = sbase + (size_t)k * 256 + cg4;
        const f32x4 sv = *(const f32x4*)(st_in + o); const float qk = qf[k], kk = kf[k];
        qs = qs + sv * qk; *(f32x4*)(st_out + o) = sv * gamma + vv * kk; }
    *(LAS f32x4*)(part + kr0 * 256 + cg4) = qs;
    __syncthreads();
    if (tid < 256) { float qk = 0.f;
        for (int j = 0; j < 256; ++j) qk += qf[j] * kf[j];
        float a = 0.f;
#pragma unroll
        for (int w = 0; w < 8; ++w) a += part[w * 256 + tid];
        const float o = qk * vf[tid] + gamma * a;
        OB[(size_t)(MPROMPT + s) * 1024 + h * 256 + tid] = (bf16)(pk2(o, 0.f) & 0xffffu); }
}

__device__ __forceinline__ void phase_mixer(int l, ldsp lds, int tid) {
    asm volatile("" : "+v"(tid));
    unsigned char* ws = ARG_WS; bf16* PROJ = (bf16*)(ws + WS_PROJ); bf16* OB = (bf16*)(ws + WS_OB);
    const int bx = blockIdx.x, G = gridDim.x; const int x = bx & 7, i = bx >> 3, per = G >> 3;
    const int nchain_wg = (per / 2) * 8;
    if (i < per / 2) {
        for (int c = x * (per / 2) + i; c < 128; c += nchain_wg) { const int bh = c >> 2, vs = c & 3;
            chain_unit(PROJ, OB, ARG_OUT + OUT_RP + (size_t)l * 8 * 4 * 65536, lds, bh >> 2, bh & 3, vs, tid); }
    } else {
        const int oid = x * (per - per / 2) + (i - per / 2), nother = (per - per / 2) * 8;
        for (int u = oid; u < 512; u += nother) sample_unit(PROJ, OB, ARG_IN(2) + (size_t)l * 128 * 4 * 65536, ARG_OUT + OUT_RS + (size_t)l * 128 * 4 * 65536, lds, u >> 2, u & 3, tid);
        for (int u = oid; u < 512; u += nother) { const int g = u & 3, cn = u >> 2;
            gmlp_unit(PROJ, ARG_IN(11) + (size_t)(l * 4 + g) * 16384, ARG_IN(12) + (size_t)(l * 4 + g) * 128, lds, cn * 128, g, tid); }
    }
}

constexpr int NPH = 39;
__global__ void __launch_bounds__(NTHR, 2) fwd_kernel(Args args_unused) {
    extern __shared__ __attribute__((aligned(16))) unsigned char lds_raw[];
    ldsp lds = (ldsp)lds_raw;
    const int tid = threadIdx.x, lane = tid & 63, wave = __builtin_amdgcn_readfirstlane(tid >> 6);
    const int G = gridDim.x, bx = blockIdx.x;
    const int vcu = (G % 8 == 0) ? (bx % 8) * (G / 8) + bx / 8 : bx;
    const int gw = vcu * NWAVES + wave, NGW = G * NWAVES;
#define ws ARG_WS
#define X ((float*)(ARG_WS + WS_X))
#define HN ((bf16*)(ARG_WS + WS_HN))
#define OB ((bf16*)(ARG_WS + WS_OB))
#define PROJ ((bf16*)(ARG_WS + WS_PROJ))
#define modl ((const float*)(ARG_WS + WS_MOD) + l * 6144)
    const int lo = ARG_I32(168), hi = ARG_I32(172);
#define IN(k) (lo <= (k) && (k) < hi)
#define SEAM(k) do { if ((k) + 1 < hi) { if (ARG_I32(176)) cg::this_grid().sync(); else __syncthreads(); } } while (0)
    if (IN(0)) { phase_prologue(lds, gw, NGW, wave, lane); SEAM(0); }
    if (IN(1)) {
        pg8::Gemm g{(const bf16*)(ws + WS_CB), (const bf16*)(ws + WS_WADA), 256, MODLD, 1024}; pg8::StaticOrder S; S.init(256, MODLD, G, bx);
        pg8::EpiF32Bias E{(float*)(ws + WS_MOD), MODLD, ARG_IN(6)};
        pg8::gemm_phase<pg8::EpiF32Bias, pg8::StaticOrder, false, true>(lds, g, S, E);
        SEAM(1);
    }
#pragma unroll 1
    for (int l = 0; l < NL; ++l) {
        const int pb = 2 + 9 * l;
        if (IN(pb + 0)) { phase_norm_mod(X, ARG_IN(7) + l * 1024, modl, 0, 1, HN, gw, NGW, lane); SEAM(pb + 0); }
        if (IN(pb + 1)) {
            pg8::Gemm g{HN, (const bf16*)(ws + WS_WIN) + (size_t)l * DIN * 1024, MP, DIN, 1024}; pg8::EpiBf16Act E{PROJ, DIN, 0};
            pg8::StaticOrder S; S.init(MP, DIN, G, bx);
            pg8::gemm_phase<pg8::EpiBf16Act, pg8::StaticOrder, true, true>(lds, g, S, E);
            SEAM(pb + 1);
        }
        if (IN(pb + 2)) { phase_post(PROJ, ARG_IN(9) + l * 1024, ARG_IN(10) + l * 1024, (const float*)(ws + WS_TAB), ARG_OUT + OUT_CV + (size_t)l * NSMP * 1024, gw, NGW, lane); SEAM(pb + 2); }
        if (IN(pb + 3)) { phase_mixer(l, lds, tid); SEAM(pb + 3); }
        if (IN(pb + 4)) { phase_merge(PROJ, OB, ARG_IN(13) + l * 1024, ARG_IN(11) + (size_t)l * 4 * 16384, ARG_IN(12) + l * 4 * 128, HN, gw, NGW, lane); SEAM(pb + 4); }
        if (IN(pb + 5)) {
            pg8::Gemm g{HN, (const bf16*)(ws + WS_WOUT) + (size_t)l * 1024 * 1024, MP, 1024, 1024}; pg8::EpiResGate E{X, modl + 2 * 1024};
            pg8::StaticOrder S; S.init(MP, 1024, G, bx);
            pg8::gemm_phase<pg8::EpiResGate, pg8::StaticOrder, true, true>(lds, g, S, E);
            SEAM(pb + 5);
        }
        if (IN(pb + 6)) { phase_norm_mod(X, ARG_IN(15) + l * 1024, modl, 3, 4, HN, gw, NGW, lane); SEAM(pb + 6); }
        if (IN(pb + 7)) {
            pg8::Gemm g{HN, (const bf16*)(ws + WS_WFF1) + (size_t)l * DFF * 1024, MP, DFF, 1024}; pg8::EpiBf16Act E{PROJ, DFF, 1};
            pg8::StaticOrder S; S.init(MP, DFF, G, bx);
            pg8::gemm_phase<pg8::EpiBf16Act, pg8::StaticOrder, true, true>(lds, g, S, E);
            SEAM(pb + 7);
        }
        if (IN(pb + 8)) {
            pg8::Gemm g{PROJ, (const bf16*)(ws + WS_WFF2) + (size_t)l * 1024 * DFF, MP, 1024, DFF}; pg8::EpiResGate E{X, modl + 5 * 1024};
            pg8::StaticOrder S; S.init(MP, 1024, G, bx);
            pg8::gemm_phase<pg8::EpiResGate, pg8::StaticOrder, true, true>(lds, g, S, E);
            SEAM(pb + 8);
        }
    }
    if (IN(NPH - 1)) phase_final_norm(X, ARG_IN(18), ARG_OUT, gw, NGW, lane);
#undef IN
#undef SEAM
#undef ws
#undef X
#undef HN
#undef OB
#undef PROJ
#undef modl
}

#ifndef MK_MULTI
#define MK_MULTI 1
#endif
extern "C" void kernel_launch(void* const* d_in, const int* in_sizes, int n_in, void* d_out, int out_size, void* d_ws, size_t ws_size, hipStream_t stream) {
    static int grid = 0;
    if (grid == 0) {
        if (n_in != 19 || (size_t)out_size != OUT_TOTAL || ws_size < WS_END) { fprintf(stderr, "kernel_launch: unexpected shapes (n_in %d out %d ws %zu)\n", n_in, out_size, ws_size); grid = -1; return; }
        int dev = 0, cus = 0, per_cu = 0;
        if (hipGetDevice(&dev) != hipSuccess || hipDeviceGetAttribute(&cus, hipDeviceAttributeMultiprocessorCount, dev) != hipSuccess) { grid = -1; return; }
        if (hipFuncSetAttribute((const void*)fwd_kernel, hipFuncAttributeMaxDynamicSharedMemorySize, LDS_BYTES) != hipSuccess) { fprintf(stderr, "kernel_launch: hipFuncSetAttribute failed\n"); grid = -1; return; }
        if (hipOccupancyMaxActiveBlocksPerMultiprocessor(&per_cu, (const void*)fwd_kernel, NTHR, LDS_BYTES) != hipSuccess || per_cu < 1) { fprintf(stderr, "kernel_launch: occupancy query says %d blocks per CU\n", per_cu); grid = -1; return; }
        grid = cus;
    }
    if (grid < 0) return;
    Args a{};
    for (int i = 0; i < 19; ++i) a.in[i] = (const float*)d_in[i];
    a.out = (float*)d_out; a.ws = (unsigned char*)d_ws;
#if MK_MULTI
    for (int p = 0; p < NPH; ++p) { a.ph_lo = p; a.ph_hi = p + 1; a.coop = 0; hipLaunchKernelGGL(fwd_kernel, dim3(grid), dim3(NTHR), LDS_BYTES, stream, a); }
#else
    a.ph_lo = 0; a.ph_hi = NPH; a.coop = 1;
    void* params[] = {&a};
    hipError_t e = hipLaunchCooperativeKernel((const void*)fwd_kernel, dim3(grid), dim3(NTHR), params, LDS_BYTES, stream);
    if (e != hipSuccess) fprintf(stderr, "cooperative launch failed: %s (grid %d)\n", hipGetErrorString(e), grid);
#endif
}
```
